# Optimizing an MI355X kernel written in HIP

```python
import jax, jax.numpy as jnp
from jax import lax
import numpy as np

D_MODEL = 1024
BATCH = 1
SEQ = 16384
DEPTH = 2

CHUNK = 64
N_EVEN = (DEPTH + 1) // 2
N_ODD = DEPTH // 2
POOL_WINDOWS = (2, 4, 8, 16)
N_POOL_GROUPS = 4
POOL_WIDTH = D_MODEL // 2
POOL_GROUP = POOL_WIDTH // N_POOL_GROUPS
SB_HEAD_DIM = 64
SB_HEADS = (D_MODEL // 2) // SB_HEAD_DIM
SB_WIDTH = SB_HEADS * SB_HEAD_DIM
SB_BLOCK = 128
IN_WIDTH = POOL_WIDTH + 3 * SB_WIDTH
MIX_WIDTH = POOL_WIDTH + SB_WIDTH
RW_HEAD = 64
RW_HEADS = D_MODEL // RW_HEAD
W_LORA = 64
A_LORA = 64
G_LORA = 160
GN_EPS = 64e-5
N_EXPERTS = 64
TOP_K = 8
N_GROUPS = 8
TOPK_GROUPS = 4
EXPERT_FF = 256
SHARED_FF = 256
ROUTED_SCALE = 2.5
MOE_BLOCK = 128
DN_ALPHA = (2.0 * DEPTH) ** 0.25
DN_BETA = (8.0 * DEPTH) ** -0.25
LN_EPS = 1e-5

kernel_name = 'hybrid_pool_stickbreak_rwkv7_moe'


def _layer_norm(x, g, b):
    xf = x.astype(jnp.float32)
    mu = jnp.mean(xf, axis=-1, keepdims=True)
    var = jnp.mean(jnp.square(xf - mu), axis=-1, keepdims=True)
    return ((xf - mu) * lax.rsqrt(var + LN_EPS) * g + b).astype(x.dtype)


def _pool_mixer(u, pool_w, pool_scale):
    b, s, _ = u.shape
    uf = u.astype(jnp.float32).reshape(b, s, N_POOL_GROUPS, POOL_GROUP)
    csum = jnp.concatenate([jnp.zeros((b, 1, N_POOL_GROUPS, POOL_GROUP), jnp.float32),
                            jnp.cumsum(uf, axis=1)], axis=1)
    t = jnp.arange(s)
    means = []
    for g, win in enumerate(POOL_WINDOWS):
        lo = jnp.maximum(t + 1 - win, 0)
        cnt = (t + 1 - lo).astype(jnp.float32)
        window_sum = csum[:, 1:, g] - jnp.take(csum[:, :, g], lo, axis=1)
        means.append(window_sum / cnt[None, :, None])
    pooled = jnp.stack(means, axis=2)
    diff = (pooled - uf).astype(u.dtype)
    y = jnp.einsum('bsgc,gcd->bsgd', diff, pool_w)
    return y.reshape(b, s, POOL_WIDTH) * pool_scale


def _stick_breaking(q, k, v):
    b, h, s, dh = q.shape
    nb = s // SB_BLOCK
    qb = q.astype(jnp.float32).reshape(b, h, nb, SB_BLOCK, dh).transpose(2, 0, 1, 3, 4)
    kf = k.astype(jnp.float32)
    vf = v.astype(jnp.float32)
    key_pos = jnp.arange(s)
    scale = dh ** -0.5

    def block(args):
        qi, bi = args
        z = jnp.einsum('bhqd,bhkd->bhqk', qi, kf) * scale
        q_pos = bi * SB_BLOCK + jnp.arange(SB_BLOCK)
        past = key_pos[None, :] < q_pos[:, None]
        log_fail = jnp.where(past, -jax.nn.softplus(z), 0.0)
        between = lax.cumsum(log_fail, axis=3, reverse=True) - log_fail
        w = jnp.where(past, jnp.exp(jax.nn.log_sigmoid(z) + between), 0.0)
        return jnp.einsum('bhqk,bhkd->bhqd', w, vf)

    o = lax.map(block, (qb, jnp.arange(nb)))
    return o.transpose(1, 2, 0, 3, 4).reshape(b, h, s, dh).astype(q.dtype)


def _even_mixer(x, w_in, pool_w, pool_scale, w_out):
    b, s, _ = x.shape
    hcat = x @ w_in
    u, q, k, v = jnp.split(hcat, [POOL_WIDTH, POOL_WIDTH + SB_WIDTH, POOL_WIDTH + 2 * SB_WIDTH], axis=-1)
    y_pool = _pool_mixer(u, pool_w, pool_scale)
    to_heads = lambda t: t.reshape(b, s, SB_HEADS, SB_HEAD_DIM).transpose(0, 2, 1, 3)
    y_sb = _stick_breaking(to_heads(q), to_heads(k), to_heads(v))
    y_sb = y_sb.transpose(0, 2, 1, 3).reshape(b, s, SB_WIDTH)
    return jnp.concatenate([y_pool, y_sb], axis=-1) @ w_out


def _rwkv7_mixer(x, mu, w_r, w_k, w_v, w_w1, w_w2, w0, a1, a2, a0, g1, g2,
                 k_k, k_a, r_k, lnx_g, lnx_b, w_o):
    b, s, d = x.shape
    hh, n = RW_HEADS, RW_HEAD
    xx = jnp.pad(x, ((0, 0), (1, 0), (0, 0)))[:, :-1] - x
    xr, xw, xk, xv, xa, xg = [x + xx * mu[i] for i in range(6)]
    r = xr @ w_r
    w_log = -jax.nn.softplus(-(w0 + jnp.tanh(xw @ w_w1) @ w_w2)) - 0.5
    k = xk @ w_k
    v = xv @ w_v
    a = jax.nn.sigmoid(a0 + (xa @ a1) @ a2)
    g = jax.nn.sigmoid(xg @ g1) @ g2
    heads = lambda t: t.astype(jnp.float32).reshape(b, s, hh, n)
    kk = heads(k * k_k)
    kk = kk / jnp.maximum(jnp.sqrt(jnp.sum(jnp.square(kk), axis=-1, keepdims=True)), 1e-12)
    k = k * (1.0 + (a - 1.0) * k_a)
    rh, kh, vh, ah = heads(r), heads(k), heads(v), heads(a)
    decay = jnp.exp(-jnp.exp(heads(w_log)))

    def step(state, inp):
        r_t, d_t, k_t, v_t, kk_t, a_t = inp
        sa = jnp.einsum('bhvk,bhk->bhv', state, kk_t)
        state = (state * d_t[:, :, None, :] - sa[..., None] * (kk_t * a_t)[:, :, None, :]
                 + v_t[..., None] * k_t[:, :, None, :])
        return state, jnp.einsum('bhvk,bhk->bhv', state, r_t)

    seq_major = lambda t: jnp.swapaxes(t, 0, 1)
    inputs = (seq_major(rh), seq_major(decay), seq_major(kh), seq_major(vh), seq_major(kk), seq_major(ah))
    _, y = lax.scan(step, jnp.zeros((b, hh, n, n), jnp.float32), inputs)
    y = jnp.swapaxes(y, 0, 1)
    ym = jnp.mean(y, axis=-1, keepdims=True)
    yv = jnp.mean(jnp.square(y - ym), axis=-1, keepdims=True)
    y = ((y - ym) * lax.rsqrt(yv + GN_EPS)).reshape(b, s, d) * lnx_g + lnx_b
    bonus = jnp.sum(rh * kh * r_k, axis=-1, keepdims=True) * vh
    y = (y + bonus.reshape(b, s, d)).astype(x.dtype)
    return (y * g) @ w_o


def _swiglu(h, wg, wu, wd):
    return (jax.nn.silu(h @ wg) * (h @ wu)) @ wd


def _routed_experts(xf, idx, gates, w_gate, w_up, w_down):
    n, d = xf.shape
    n_assign = n * TOP_K
    n_blocks = -(-n_assign // MOE_BLOCK) + N_EXPERTS
    n_slots = n_blocks * MOE_BLOCK
    e_flat = idx.reshape(-1)
    tok_flat = jnp.repeat(jnp.arange(n, dtype=jnp.int32), TOP_K)
    g_flat = gates.reshape(-1)
    order = jnp.argsort(e_flat)
    e_sorted = e_flat[order]
    counts = jnp.zeros((N_EXPERTS,), jnp.int32).at[e_flat].add(1)
    padded = (counts + MOE_BLOCK - 1) // MOE_BLOCK * MOE_BLOCK
    start = jnp.cumsum(counts) - counts
    pad_end = jnp.cumsum(padded)
    pad_start = pad_end - padded
    dest = pad_start[e_sorted] + (jnp.arange(n_assign, dtype=jnp.int32) - start[e_sorted])
    slot_tok = jnp.full((n_slots,), n, jnp.int32).at[dest].set(tok_flat[order])
    slot_gate = jnp.zeros((n_slots,), jnp.float32).at[dest].set(g_flat[order])
    block_start = jnp.arange(n_blocks, dtype=jnp.int32) * MOE_BLOCK
    block_expert = jnp.minimum(jnp.searchsorted(pad_end, block_start, side='right'), N_EXPERTS - 1)
    x_pad = jnp.concatenate([xf, jnp.zeros((1, d), xf.dtype)], axis=0)
    xs = x_pad[slot_tok].reshape(n_blocks, MOE_BLOCK, d)

    def expert_block(args):
        xb, e = args
        return _swiglu(xb, w_gate[e], w_up[e], w_down[e])

    ys = lax.map(expert_block, (xs, block_expert)).reshape(n_slots, d)
    ys = ys.astype(jnp.float32) * slot_gate[:, None]
    out = jnp.zeros((n + 1, d), jnp.float32).at[slot_tok].add(ys)[:n]
    return out.astype(xf.dtype)


def _moe(x, w_router, e_bias, w_gate, w_up, w_down, ws_gate, ws_up, ws_down):
    b, s, d = x.shape
    xf = x.reshape(b * s, d)
    n = xf.shape[0]
    scores = jax.nn.sigmoid((xf @ w_router).astype(jnp.float32))
    biased = scores + e_bias
    grp_score = jnp.sum(lax.top_k(biased.reshape(n, N_GROUPS, N_EXPERTS // N_GROUPS), 2)[0], axis=-1)
    _, top_grp = lax.top_k(grp_score, TOPK_GROUPS)
    grp_mask = jnp.any(top_grp[:, :, None] == jnp.arange(N_GROUPS)[None, None, :], axis=1)
    expert_mask = jnp.repeat(grp_mask, N_EXPERTS // N_GROUPS, axis=1)
    _, idx = lax.top_k(jnp.where(expert_mask, biased, -jnp.inf), TOP_K)
    sel = jnp.take_along_axis(scores, idx, axis=1)
    gates = sel / jnp.sum(sel, axis=-1, keepdims=True) * ROUTED_SCALE
    routed = _routed_experts(xf, idx, gates, w_gate, w_up, w_down)
    shared = _swiglu(xf, ws_gate, ws_up, ws_down)
    return (routed + shared).reshape(b, s, d)


def setup_inputs(seed: int = 0) -> dict:
    key = jax.random.key(seed)
    ks = iter(jax.random.split(key, 48))
    f32 = jnp.float32
    nrm = lambda shape, sc: sc * jax.random.normal(next(ks), shape, f32)
    uni = lambda shape, lo, hi: jax.random.uniform(next(ks), shape, f32, lo, hi)
    D = D_MODEL
    return {
        'x': nrm((BATCH, SEQ, D), 1.0),
        'ln_mix_g': 1.0 + nrm((DEPTH, D), 0.05),
        'ln_mix_b': nrm((DEPTH, D), 0.01),
        'ln_ffn_g': 1.0 + nrm((DEPTH, D), 0.05),
        'ln_ffn_b': nrm((DEPTH, D), 0.01),
        'ab_w_in': nrm((N_EVEN, D, IN_WIDTH), D ** -0.5),
        'ab_pool_w': nrm((N_EVEN, N_POOL_GROUPS, POOL_GROUP, POOL_GROUP), POOL_GROUP ** -0.5),
        'ab_pool_scale': 1.0 + nrm((N_EVEN, POOL_WIDTH), 0.1),
        'ab_w_out': nrm((N_EVEN, MIX_WIDTH, D), DN_BETA * MIX_WIDTH ** -0.5),
        'rw_mu': uni((N_ODD, 6, D), 0.0, 1.0),
        'rw_w_r': nrm((N_ODD, D, D), D ** -0.5),
        'rw_w_k': nrm((N_ODD, D, D), D ** -0.5),
        'rw_w_v': nrm((N_ODD, D, D), D ** -0.5),
        'rw_w_w1': nrm((N_ODD, D, W_LORA), D ** -0.5),
        'rw_w_w2': nrm((N_ODD, W_LORA, D), 0.5 * W_LORA ** -0.5),
        'rw_w0': uni((N_ODD, D), -6.0, -1.0),
        'rw_a1': nrm((N_ODD, D, A_LORA), D ** -0.5),
        'rw_a2': nrm((N_ODD, A_LORA, D), 0.5 * A_LORA ** -0.5),
        'rw_a0': nrm((N_ODD, D), 0.5),
        'rw_g1': nrm((N_ODD, D, G_LORA), D ** -0.5),
        'rw_g2': nrm((N_ODD, G_LORA, D), G_LORA ** -0.5),
        'rw_k_k': 0.85 + nrm((N_ODD, D), 0.05),
        'rw_k_a': 1.0 + nrm((N_ODD, D), 0.05),
        'rw_r_k': nrm((N_ODD, RW_HEADS, RW_HEAD), 0.1),
        'rw_lnx_g': 1.0 + nrm((N_ODD, D), 0.05),
        'rw_lnx_b': nrm((N_ODD, D), 0.01),
        'rw_w_o': nrm((N_ODD, D, D), DN_BETA * D ** -0.5),
        'moe_w_router': nrm((DEPTH, D, N_EXPERTS), D ** -0.5),
        'moe_e_bias': nrm((DEPTH, N_EXPERTS), 0.01),
        'moe_w_gate': nrm((DEPTH, N_EXPERTS, D, EXPERT_FF), D ** -0.5),
        'moe_w_up': nrm((DEPTH, N_EXPERTS, D, EXPERT_FF), D ** -0.5),
        'moe_w_down': nrm((DEPTH, N_EXPERTS, EXPERT_FF, D), DN_BETA * EXPERT_FF ** -0.5),
        'moe_ws_gate': nrm((DEPTH, D, SHARED_FF), D ** -0.5),
        'moe_ws_up': nrm((DEPTH, D, SHARED_FF), D ** -0.5),
        'moe_ws_down': nrm((DEPTH, SHARED_FF, D), DN_BETA * SHARED_FF ** -0.5),
    }


def reference(x, ln_mix_g, ln_mix_b, ln_ffn_g, ln_ffn_b,
              ab_w_in, ab_pool_w, ab_pool_scale, ab_w_out,
              rw_mu, rw_w_r, rw_w_k, rw_w_v, rw_w_w1, rw_w_w2, rw_w0, rw_a1, rw_a2, rw_a0,
              rw_g1, rw_g2, rw_k_k, rw_k_a, rw_r_k, rw_lnx_g, rw_lnx_b, rw_w_o,
              moe_w_router, moe_e_bias, moe_w_gate, moe_w_up, moe_w_down,
              moe_ws_gate, moe_ws_up, moe_ws_down):
    for layer in range(DEPTH):
        i = layer // 2
        if layer % 2 == 0:
            mix = _even_mixer(x, ab_w_in[i], ab_pool_w[i], ab_pool_scale[i], ab_w_out[i])
        else:
            mix = _rwkv7_mixer(x, rw_mu[i], rw_w_r[i], rw_w_k[i], rw_w_v[i], rw_w_w1[i], rw_w_w2[i],
                               rw_w0[i], rw_a1[i], rw_a2[i], rw_a0[i], rw_g1[i], rw_g2[i],
                               rw_k_k[i], rw_k_a[i], rw_r_k[i], rw_lnx_g[i], rw_lnx_b[i], rw_w_o[i])
        x = _layer_norm(DN_ALPHA * x + mix, ln_mix_g[layer], ln_mix_b[layer])
        ff = _moe(x, moe_w_router[layer], moe_e_bias[layer], moe_w_gate[layer], moe_w_up[layer],
                  moe_w_down[layer], moe_ws_gate[layer], moe_ws_up[layer], moe_ws_down[layer])
        x = _layer_norm(DN_ALPHA * x + ff, ln_ffn_g[layer], ln_ffn_b[layer])
    return x
```

```cpp
#include <hip/hip_runtime.h>
#include <cstdio>
#include <cstdint>
#include <cmath>
namespace nv {
constexpr int S = 16384, D = 1024;
constexpr float ALPHA = 1.41421356237309515f, LNEPS = 1e-5f;

__device__ __forceinline__ float softplusf(float z) { return z > 20.f ? z : log1pf(expf(z)); }
__device__ __forceinline__ float sigmoidf_(float z) { return 1.f / (1.f + expf(-z)); }
__device__ __forceinline__ float wave_sum(float v) {
#pragma unroll
    for (int o = 1; o < 64; o <<= 1) v += __shfl_xor(v, o);
    return v;
}

__global__ void __launch_bounds__(256) gemm_f32(const float* __restrict__ A, int lda, const float* __restrict__ W, int ldw, float* __restrict__ C, int ldc, int M, int N, int K) {
    __shared__ float As[16][64 + 4];
    __shared__ float Ws[16][64 + 4];
    const int tid = threadIdx.x, tx = tid & 15, ty = tid >> 4;
    const int m0 = blockIdx.y * 64, n0 = blockIdx.x * 64;
    float acc[4][4];
#pragma unroll
    for (int i = 0; i < 4; ++i)
#pragma unroll
        for (int j = 0; j < 4; ++j) acc[i][j] = 0.f;
    for (int k0 = 0; k0 < K; k0 += 16) {
#pragma unroll
        for (int i = 0; i < 4; ++i) { const int e = tid + i * 256, r = e >> 4, kk = e & 15; As[kk][r] = A[(size_t)(m0 + r) * lda + k0 + kk]; }
#pragma unroll
        for (int i = 0; i < 4; ++i) { const int e = tid + i * 256, kk = e >> 6, c = e & 63; Ws[kk][c] = (n0 + c < N) ? W[(size_t)(k0 + kk) * ldw + n0 + c] : 0.f; }
        __syncthreads();
#pragma unroll
        for (int kk = 0; kk < 16; ++kk) {
            float a[4], b[4];
#pragma unroll
            for (int i = 0; i < 4; ++i) a[i] = As[kk][ty * 4 + i];
#pragma unroll
            for (int j = 0; j < 4; ++j) b[j] = Ws[kk][tx * 4 + j];
#pragma unroll
            for (int i = 0; i < 4; ++i)
#pragma unroll
                for (int j = 0; j < 4; ++j) acc[i][j] = fmaf(a[i], b[j], acc[i][j]);
        }
        __syncthreads();
    }
#pragma unroll
    for (int i = 0; i < 4; ++i)
#pragma unroll
        for (int j = 0; j < 4; ++j) { const int n = n0 + tx * 4 + j; if (n < N) C[(size_t)(m0 + ty * 4 + i) * ldc + n] = acc[i][j]; }
}
static void gemm(hipStream_t st, const float* A, int lda, const float* W, int ldw, float* C, int ldc, int M, int N, int K) {
    gemm_f32<<<dim3((N + 63) / 64, M / 64), 256, 0, st>>>(A, lda, W, ldw, C, ldc, M, N, K);
}

__global__ void pool_diff(const float* __restrict__ hcat, float* __restrict__ diff) {
    const int i = blockIdx.x * 256 + threadIdx.x; if (i >= S * 512) return;
    const int t = i >> 9, c = i & 511, g = c >> 7; const int win = 2 << g;
    const int lo = max(t + 1 - win, 0); float s = 0.f;
    for (int j = lo; j <= t; ++j) s += hcat[(size_t)j * 2048 + c];
    diff[i] = s / (float)(t + 1 - lo) - hcat[(size_t)t * 2048 + c];
}
__global__ void scale_cols(float* __restrict__ y, int ld, const float* __restrict__ sc, int ncols, int total) {
    const int i = blockIdx.x * 256 + threadIdx.x; if (i >= total) return;
    const int t = i / ncols, c = i % ncols; y[(size_t)t * ld + c] *= sc[c];
}
__global__ void __launch_bounds__(64) sb_attn(const float* __restrict__ hcat, float* __restrict__ mixin) {
    const int h = blockIdx.y, t = blockIdx.x * 64 + threadIdx.x;
    float q[64], o[64];
    const float* qp = hcat + (size_t)t * 2048 + 512 + h * 64;
#pragma unroll
    for (int d = 0; d < 64; ++d) { q[d] = qp[d] * 0.125f; o[d] = 0.f; }
    float between = 0.f;
    for (int s = t - 1; s >= 0; --s) {
        const float* kp = hcat + (size_t)s * 2048 + 1024 + h * 64;
        float z = 0.f;
#pragma unroll
        for (int d = 0; d < 64; ++d) z = fmaf(q[d], kp[d], z);
        const float sp = softplusf(z);
        const float w = expf((z - sp) + between);
        const float* vp = kp + 512;
#pragma unroll
        for (int d = 0; d < 64; ++d) o[d] = fmaf(w, vp[d], o[d]);
        between -= sp;
        if (between < -110.f) break;
    }
    float* op = mixin + (size_t)t * 1024 + 512 + h * 64;
#pragma unroll
    for (int d = 0; d < 64; ++d) op[d] = o[d];
}
__global__ void __launch_bounds__(256) ln_res(const float* __restrict__ base, const float* __restrict__ add, const float* __restrict__ g, const float* __restrict__ b, float* __restrict__ out) {
    const int row = blockIdx.x * 4 + (threadIdx.x >> 6), lane = threadIdx.x & 63;
    float v[16]; float s = 0.f;
#pragma unroll
    for (int j = 0; j < 16; ++j) { const int c = lane + 64 * j; v[j] = ALPHA * base[(size_t)row * D + c] + add[(size_t)row * D + c]; s += v[j]; }
    const float mean = wave_sum(s) * (1.f / D); float q = 0.f;
#pragma unroll
    for (int j = 0; j < 16; ++j) { v[j] -= mean; q += v[j] * v[j]; }
    const float rstd = rsqrtf(wave_sum(q) * (1.f / D) + LNEPS);
#pragma unroll
    for (int j = 0; j < 16; ++j) { const int c = lane + 64 * j; out[(size_t)row * D + c] = v[j] * rstd * g[c] + b[c]; }
}
__global__ void __launch_bounds__(256) route(const float* __restrict__ logits, const float* __restrict__ ebias, int* __restrict__ asg_e, float* __restrict__ asg_g,
                                             int* __restrict__ cnt, int* __restrict__ list, float* __restrict__ lgate) {
    const int tok = blockIdx.x * 4 + (threadIdx.x >> 6), lane = threadIdx.x & 63;
    const float score = sigmoidf_(logits[(size_t)tok * 64 + lane]);
    const float biased = score + ebias[lane];
    const int gbase = lane & ~7;
    int rank_in_grp = 0;
#pragma unroll
    for (int j = 0; j < 8; ++j) { const float o = __shfl(biased, gbase + j); const int oj = gbase + j; rank_in_grp += (o > biased || (o == biased && oj < lane)) ? 1 : 0; }
    float contrib = rank_in_grp < 2 ? biased : 0.f;
    contrib += __shfl_xor(contrib, 1); contrib += __shfl_xor(contrib, 2); contrib += __shfl_xor(contrib, 4);
    const int grp = lane >> 3;
    int grank = 0;
#pragma unroll
    for (int j = 0; j < 8; ++j) { const float o = __shfl(contrib, j * 8); grank += (o > contrib || (o == contrib && j < grp)) ? 1 : 0; }
    const bool gsel = grank < 4;
    const float mv = gsel ? biased : -INFINITY;
    int rank = 0;
    for (int j = 0; j < 64; ++j) { const float o = __shfl(mv, j); rank += (o > mv || (o == mv && j < lane)) ? 1 : 0; }
    const bool sel = gsel && rank < 8;
    const float ssum = wave_sum(sel ? score : 0.f);
    const float gate = score / ssum * 2.5f;
    const unsigned long long m = __ballot(sel);
    if (sel) {
        const int kidx = __popcll(m & ((1ull << lane) - 1ull));
        asg_e[tok * 8 + kidx] = lane; asg_g[tok * 8 + kidx] = gate;
        const int pos = atomicAdd(&cnt[lane], 1);
        list[lane * S + pos] = tok; lgate[lane * S + pos] = gate;
    }
}
__global__ void __launch_bounds__(256) moe_naive(const float* __restrict__ x, const float* __restrict__ Wg, const float* __restrict__ Wu, const float* __restrict__ Wd,
                                                 const float* __restrict__ WSg, const float* __restrict__ WSu, const float* __restrict__ WSd,
                                                 const int* __restrict__ cnt, const int* __restrict__ list, const float* __restrict__ lgate, float* __restrict__ ff) {
    const int e = blockIdx.y, grp = blockIdx.x, tid = threadIdx.x;
    const int n_e = (e == 64) ? S : cnt[e];
    if (grp * 16 >= n_e) return;
    __shared__ float xs[16][1024];
    __shared__ float hs[16][256];
    __shared__ int toks[16]; __shared__ float gts[16];
    if (tid < 16) { const int p = grp * 16 + tid; const bool ok = p < n_e; toks[tid] = ok ? (e == 64 ? p : list[e * S + p]) : -1; gts[tid] = ok ? (e == 64 ? 1.f : lgate[e * S + p]) : 0.f; }
    __syncthreads();
    for (int i = tid; i < 16 * 1024; i += 256) { const int r = i >> 10, c = i & 1023; xs[r][c] = toks[r] >= 0 ? x[(size_t)toks[r] * D + c] : 0.f; }
    __syncthreads();
    const float* wg = (e == 64) ? WSg : Wg + (size_t)e * 1024 * 256;
    const float* wu = (e == 64) ? WSu : Wu + (size_t)e * 1024 * 256;
    const float* wd = (e == 64) ? WSd : Wd + (size_t)e * 256 * 1024;
    float ag[16], au[16];
#pragma unroll
    for (int r = 0; r < 16; ++r) { ag[r] = 0.f; au[r] = 0.f; }
    for (int k = 0; k < 1024; ++k) {
        const float a = wg[(size_t)k * 256 + tid], b = wu[(size_t)k * 256 + tid];
#pragma unroll
        for (int r = 0; r < 16; ++r) { const float xv = xs[r][k]; ag[r] = fmaf(xv, a, ag[r]); au[r] = fmaf(xv, b, au[r]); }
    }
#pragma unroll
    for (int r = 0; r < 16; ++r) hs[r][tid] = (ag[r] / (1.f + expf(-ag[r]))) * au[r];
    __syncthreads();
    for (int cq = 0; cq < 4; ++cq) {
        const int n = tid + 256 * cq; float y[16];
#pragma unroll
        for (int r = 0; r < 16; ++r) y[r] = 0.f;
        for (int k = 0; k < 256; ++k) { const float w = wd[(size_t)k * 1024 + n];
#pragma unroll
            for (int r = 0; r < 16; ++r) y[r] = fmaf(hs[r][k], w, y[r]); }
#pragma unroll
        for (int r = 0; r < 16; ++r) if (toks[r] >= 0) atomicAdd(&ff[(size_t)toks[r] * D + n], gts[r] * y[r]);
    }
}
__global__ void tmix(const float* __restrict__ x, const float* __restrict__ mu, float* __restrict__ xm) {
    const size_t i = (size_t)blockIdx.x * 256 + threadIdx.x; if (i >= (size_t)S * D) return;
    const int t = (int)(i >> 10), c = (int)(i & 1023); const float xc = x[i], xp = t > 0 ? x[i - D] : 0.f;
    xm[i] = xc + (xp - xc) * mu[c];
}
__global__ void act_inplace(float* __restrict__ v, size_t n, int mode) {
    const size_t i = (size_t)blockIdx.x * 256 + threadIdx.x; if (i >= n) return;
    v[i] = mode == 1 ? tanhf(v[i]) : sigmoidf_(v[i]);
}
__global__ void __launch_bounds__(256) rw_prep(float* __restrict__ w, float* __restrict__ a, float* __restrict__ k, float* __restrict__ kkbuf,
                                               const float* __restrict__ w0, const float* __restrict__ a0, const float* __restrict__ k_k, const float* __restrict__ k_a) {
    const size_t wv = (size_t)blockIdx.x * 4 + (threadIdx.x >> 6); const int lane = threadIdx.x & 63;
    const int t = (int)(wv >> 4), h = (int)(wv & 15), c = h * 64 + lane; const size_t i = (size_t)t * D + c;
    const float wl = -softplusf(-(w0[c] + w[i])) - 0.5f;
    const float dec = expf(-expf(wl));
    const float av = sigmoidf_(a0[c] + a[i]);
    const float kv = k[i];
    float kk = kv * k_k[c];
    const float nrm = fmaxf(sqrtf(wave_sum(kk * kk)), 1e-12f);
    kk /= nrm;
    w[i] = dec; a[i] = kk * av; k[i] = kv * (1.f + (av - 1.f) * k_a[c]); kkbuf[i] = kk;
}
__global__ void __launch_bounds__(256) rw_scan(float* __restrict__ r, const float* __restrict__ dec, const float* __restrict__ k, const float* __restrict__ kk, const float* __restrict__ b, const float* __restrict__ v) {
    const int h = blockIdx.x, tid = threadIdx.x, vi = tid >> 2, q = tid & 3;
    constexpr int T = 16;
    __shared__ float sr[T][64], sd[T][64], sk[T][64], skk[T][64], sb[T][64], sv[T][64], sy[T][64];
    float s[16];
#pragma unroll
    for (int j = 0; j < 16; ++j) s[j] = 0.f;
    for (int t0 = 0; t0 < S; t0 += T) {
        __syncthreads();
        for (int i = tid; i < T * 64; i += 256) { const int tt = i >> 6, c = i & 63; const size_t gi = (size_t)(t0 + tt) * D + h * 64 + c;
            sr[tt][c] = r[gi]; sd[tt][c] = dec[gi]; sk[tt][c] = k[gi]; skk[tt][c] = kk[gi]; sb[tt][c] = b[gi]; sv[tt][c] = v[gi]; }
        __syncthreads();
        for (int tt = 0; tt < T; ++tt) {
            float sa = 0.f;
#pragma unroll
            for (int j = 0; j < 16; ++j) sa = fmaf(s[j], skk[tt][q * 16 + j], sa);
            sa += __shfl_xor(sa, 1); sa += __shfl_xor(sa, 2);
            const float vv = sv[tt][vi]; float y = 0.f;
#pragma unroll
            for (int j = 0; j < 16; ++j) { const int c = q * 16 + j; s[j] = s[j] * sd[tt][c] - sa * sb[tt][c] + vv * sk[tt][c]; y = fmaf(s[j], sr[tt][c], y); }
            y += __shfl_xor(y, 1); y += __shfl_xor(y, 2);
            if (q == 0) sy[tt][vi] = y;
        }
        __syncthreads();
        for (int i = tid; i < T * 64; i += 256) { const int tt = i >> 6, c = i & 63; const size_t gi = (size_t)(t0 + tt) * D + h * 64 + c; const_cast<float*>(dec)[gi] = sy[tt][c]; }
    }
}
__global__ void __launch_bounds__(256) rw_post(float* __restrict__ y, const float* __restrict__ r, const float* __restrict__ k, const float* __restrict__ v, const float* __restrict__ g,
                                               const float* __restrict__ r_k, const float* __restrict__ lnx_g, const float* __restrict__ lnx_b) {
    const size_t wv = (size_t)blockIdx.x * 4 + (threadIdx.x >> 6); const int lane = threadIdx.x & 63;
    const int t = (int)(wv >> 4), h = (int)(wv & 15), c = h * 64 + lane; const size_t i = (size_t)t * D + c;
    const float yv = y[i];
    const float ym = wave_sum(yv) * (1.f / 64.f); const float dv = yv - ym;
    const float var = wave_sum(dv * dv) * (1.f / 64.f);
    const float bon = wave_sum(r[i] * k[i] * r_k[c]) * v[i];
    y[i] = (dv * rsqrtf(var + 64e-5f) * lnx_g[c] + lnx_b[c] + bon) * g[i];
}
__global__ void zero_f32(float* p, size_t n) { const size_t i = (size_t)blockIdx.x * 256 + threadIdx.x; if (i < n) p[i] = 0.f; }
__global__ void zero_i32(int* p, int n) { const int i = blockIdx.x * 256 + threadIdx.x; if (i < n) p[i] = 0; }

static void moe_layer(hipStream_t st, void* const* d_in, int layer, const float* x1, float* xout, unsigned char* ws, float* ff, float* logits) {
    const float* w_router = (const float*)d_in[27] + (size_t)layer * 1024 * 64;
    const float* e_bias = (const float*)d_in[28] + layer * 64;
    const float* Wg = (const float*)d_in[29] + (size_t)layer * 64 * 1024 * 256;
    const float* Wu = (const float*)d_in[30] + (size_t)layer * 64 * 1024 * 256;
    const float* Wd = (const float*)d_in[31] + (size_t)layer * 64 * 256 * 1024;
    const float* WSg = (const float*)d_in[32] + (size_t)layer * 1024 * 256;
    const float* WSu = (const float*)d_in[33] + (size_t)layer * 1024 * 256;
    const float* WSd = (const float*)d_in[34] + (size_t)layer * 256 * 1024;
    int* cnt = (int*)ws; int* asg_e = (int*)(ws + 4096); float* asg_g = (float*)(ws + 4096 + S * 8 * 4);
    int* list = (int*)(ws + (2u << 20)); float* lgate = (float*)(ws + (2u << 20) + 64 * S * 4);
    gemm(st, x1, D, w_router, 64, logits, 64, S, 64, D);
    zero_i32<<<1, 256, 0, st>>>(cnt, 64);
    route<<<S / 4, 256, 0, st>>>(logits, e_bias, asg_e, asg_g, cnt, list, lgate);
    zero_f32<<<S * D / 256, 256, 0, st>>>(ff, (size_t)S * D);
    moe_naive<<<dim3(S / 16, 65), 256, 0, st>>>(x1, Wg, Wu, Wd, WSg, WSu, WSd, cnt, list, lgate, ff);
    ln_res<<<S / 4, 256, 0, st>>>(x1, ff, (const float*)d_in[3] + layer * D, (const float*)d_in[4] + layer * D, xout);
}

static void forward(hipStream_t st, void* const* d_in, float* out, unsigned char* ws) {
    const size_t U = (size_t)64 << 20; unsigned char* base = ws + ((size_t)16 << 20);
    float* B0 = (float*)(base + 0 * U); float* B1 = (float*)(base + 1 * U); float* B2 = (float*)(base + 2 * U); float* B3 = (float*)(base + 3 * U);
    float* B4 = (float*)(base + 4 * U); float* B5 = (float*)(base + 5 * U); float* B6 = (float*)(base + 6 * U);
    float* logits = (float*)(ws + ((size_t)10 << 20));
    const float* x = (const float*)d_in[0];
    float* hcat = B1;
    float* mixin = B3; float* diff = B4; float* mix = B5; float* x1 = B0;
    gemm(st, x, D, (const float*)d_in[5], 2048, hcat, 2048, S, 2048, D);
    pool_diff<<<S * 512 / 256, 256, 0, st>>>(hcat, diff);
    for (int g = 0; g < 4; ++g) gemm(st, diff + g * 128, 512, (const float*)d_in[6] + g * 128 * 128, 128, mixin + g * 128, 1024, S, 128, 128);
    scale_cols<<<S * 512 / 256, 256, 0, st>>>(mixin, 1024, (const float*)d_in[7], 512, S * 512);
    sb_attn<<<dim3(S / 64, 8), 64, 0, st>>>(hcat, mixin);
    gemm(st, mixin, D, (const float*)d_in[8], D, mix, D, S, D, D);
    ln_res<<<S / 4, 256, 0, st>>>(x, mix, (const float*)d_in[1], (const float*)d_in[2], x1);
    moe_layer(st, d_in, 0, x1, out, ws, B1, logits);
    const float* mu = (const float*)d_in[9];
    float* xm = B0; float* r = B1; float* k = B2; float* v = B3; float* w = B4; float* a = B5; float* g = B6;
    float* mid = (float*)(ws + ((size_t)480 << 20));
    const int EW = S * D / 256;
    tmix<<<EW, 256, 0, st>>>(out, mu + 0 * D, xm); gemm(st, xm, D, (const float*)d_in[10], D, r, D, S, D, D);
    tmix<<<EW, 256, 0, st>>>(out, mu + 2 * D, xm); gemm(st, xm, D, (const float*)d_in[11], D, k, D, S, D, D);
    tmix<<<EW, 256, 0, st>>>(out, mu + 3 * D, xm); gemm(st, xm, D, (const float*)d_in[12], D, v, D, S, D, D);
    tmix<<<EW, 256, 0, st>>>(out, mu + 1 * D, xm); gemm(st, xm, D, (const float*)d_in[13], 64, mid, 64, S, 64, D);
    act_inplace<<<S * 64 / 256, 256, 0, st>>>(mid, (size_t)S * 64, 1); gemm(st, mid, 64, (const float*)d_in[14], D, w, D, S, D, 64);
    tmix<<<EW, 256, 0, st>>>(out, mu + 4 * D, xm); gemm(st, xm, D, (const float*)d_in[16], 64, mid, 64, S, 64, D);
    gemm(st, mid, 64, (const float*)d_in[17], D, a, D, S, D, 64);
    tmix<<<EW, 256, 0, st>>>(out, mu + 5 * D, xm); gemm(st, xm, D, (const float*)d_in[19], 160, mid, 160, S, 160, D);
    act_inplace<<<S * 160 / 256, 256, 0, st>>>(mid, (size_t)S * 160, 2); gemm(st, mid, 160, (const float*)d_in[20], D, g, D, S, D, 160);
    float* kk = B0;
    rw_prep<<<S * 16 / 4, 256, 0, st>>>(w, a, k, kk, (const float*)d_in[15], (const float*)d_in[18], (const float*)d_in[21], (const float*)d_in[22]);
    rw_scan<<<16, 256, 0, st>>>(r, w, k, kk, a, v);
    rw_post<<<S * 16 / 4, 256, 0, st>>>(w, r, k, v, g, (const float*)d_in[23], (const float*)d_in[24], (const float*)d_in[25]);
    float* mix1 = B0; float* x3 = B1;
    gemm(st, w, D, (const float*)d_in[26], D, mix1, D, S, D, D);
    ln_res<<<S / 4, 256, 0, st>>>(out, mix1, (const float*)d_in[1] + D, (const float*)d_in[2] + D, x3);
    moe_layer(st, d_in, 1, x3, out, ws, B2, logits);
}
}
extern "C" void kernel_launch(void* const* d_in, const int* in_sizes, int n_in, void* d_out, int out_size, void* d_ws, size_t ws_size, hipStream_t stream) {
    if (n_in != 35 || out_size != 16384 * 1024 || ws_size < ((size_t)496 << 20)) { fprintf(stderr, "kernel_launch: unexpected shapes/ws (%d %d %zu)\n", n_in, out_size, ws_size); return; }
    nv::forward(stream, d_in, (float*)d_out, (unsigned char*)d_ws);
}
```
